# Optimizing an MI355X kernel written in HIP

```python
import jax, jax.numpy as jnp
from jax import lax
import numpy as np

D_MODEL = 1024
BATCH = 1
SEQ = 16384
DEPTH = 2

HEAD_DIM = 64
D_FF = 2816
D_PLE = 256
ATTN_Q_HEADS = 8
ATTN_KV_HEADS = 2
ATTN_GROUP = ATTN_Q_HEADS // ATTN_KV_HEADS
WINDOW = 128
ROPE_THETA = 500000.0
ROPE_DIM = HEAD_DIM // 4
MLSTM_HEADS = 4
MLSTM_CHUNK = 64
MLSTM_CONV = 4
GATE_CAP = 15.0
RWKV_HEADS = 4
RWKV_W_RANK = 64
RWKV_A_RANK = 64
RWKV_G_RANK = 128
RWKV_GN_EPS = 64e-5
NORM_EPS = 1e-6
NEG_INF = -1e30

ATTN_W = ATTN_Q_HEADS * HEAD_DIM
KV_W = ATTN_KV_HEADS * HEAD_DIM
MLSTM_W = MLSTM_HEADS * HEAD_DIM
RWKV_W = RWKV_HEADS * HEAD_DIM
D_MIX = ATTN_W + MLSTM_W + RWKV_W
ATTN_COLS = ATTN_W + 2 * KV_W
MLSTM_COLS = 4 * MLSTM_W + 2 * MLSTM_HEADS
RWKV_COLS = 3 * RWKV_W + RWKV_W_RANK + RWKV_A_RANK + RWKV_G_RANK
D_IN = ATTN_COLS + MLSTM_COLS + RWKV_COLS

kernel_name = "hybrid_mlstm_swa_rwkv7_block"


def rms_norm(x, gain):
    xf = x.astype(jnp.float32)
    y = xf * lax.rsqrt(jnp.mean(xf * xf, axis=-1, keepdims=True) + NORM_EPS)
    return (y * gain.astype(jnp.float32)).astype(x.dtype)


def swiglu(x, w_in, w_out):
    gate, up = jnp.split(x @ w_in, 2, axis=-1)
    return (jax.nn.silu(gate) * up) @ w_out


def rope_tables(positions):
    inv_freq = ROPE_THETA ** (-jnp.arange(0, ROPE_DIM, 2, dtype=jnp.float32) / ROPE_DIM)
    ang = positions.astype(jnp.float32)[..., None] * inv_freq
    return jnp.cos(ang)[:, :, None, :], jnp.sin(ang)[:, :, None, :]


def partial_rope(x, cos, sin):
    half = ROPE_DIM // 2
    x1 = x[..., :half].astype(jnp.float32)
    x2 = x[..., half:ROPE_DIM].astype(jnp.float32)
    rot = jnp.concatenate([x1 * cos - x2 * sin, x2 * cos + x1 * sin], axis=-1).astype(x.dtype)
    return jnp.concatenate([rot, x[..., ROPE_DIM:]], axis=-1)


def sliding_window_gqa(q, k, v, sinks):
    B, S = q.shape[:2]
    nb = S // WINDOW
    qb = q.reshape(B, nb, WINDOW, ATTN_KV_HEADS, ATTN_GROUP, HEAD_DIM)

    def band_keys(t):
        tb = t.reshape(B, nb, WINDOW, ATTN_KV_HEADS, HEAD_DIM)
        prev = jnp.pad(tb[:, :-1], ((0, 0), (1, 0), (0, 0), (0, 0), (0, 0)))
        return jnp.concatenate([prev, tb], axis=2)

    kb, vb = band_keys(k), band_keys(v)
    scores = jnp.einsum('bnqhgd,bnkhd->bnhgqk', qb, kb).astype(jnp.float32) * (HEAD_DIM ** -0.5)
    qi = jnp.arange(WINDOW)[:, None]
    kj = jnp.arange(2 * WINDOW)[None, :]
    lag = qi + WINDOW - kj
    in_band = (lag >= 0) & (lag < WINDOW)
    blk = jnp.arange(nb)[:, None, None]
    valid = in_band[None] & ((blk > 0) | (kj >= WINDOW)[None])
    scores = jnp.where(valid[None, :, None, None], scores, NEG_INF)
    sink = jnp.broadcast_to(
        sinks.astype(jnp.float32).reshape(1, 1, ATTN_KV_HEADS, ATTN_GROUP, 1, 1),
        scores.shape[:-1] + (1,))
    probs = jax.nn.softmax(jnp.concatenate([scores, sink], axis=-1), axis=-1)[..., :-1]
    out = jnp.einsum('bnhgqk,bnkhd->bnqhgd', probs.astype(v.dtype), vb)
    return out.reshape(B, S, ATTN_W)


def causal_depthwise_conv(x, w):
    return lax.conv_general_dilated(
        x, w[:, None, :].astype(x.dtype), window_strides=(1,),
        padding=((w.shape[0] - 1, 0),), dimension_numbers=('NWC', 'WIO', 'NWC'),
        feature_group_count=x.shape[-1])


def mlstm_chunkwise(q, k, v, i_pre, f_pre):
    B, S, H, D = q.shape
    L = MLSTM_CHUNK
    nc = S // L

    def chunks(t):
        return jnp.moveaxis(t.reshape((B, nc, L, H) + t.shape[3:]), 3, 1)

    q = chunks(q * (D ** -0.5))
    k = chunks(k)
    v = chunks(v)
    ig = chunks(i_pre)
    g = jnp.cumsum(chunks(jax.nn.log_sigmoid(f_pre)), axis=-1)
    g_tot = g[..., -1]

    a = g_tot[..., None] - g + ig
    m_loc = jnp.max(a, axis=-1)
    w_loc = jnp.exp(a - m_loc[..., None])
    c_loc = jnp.einsum('bhcl,bhclv,bhclk->bhcvk', w_loc, v, k)
    n_loc = jnp.einsum('bhcl,bhclk->bhck', w_loc, k)

    def carry_state(state, xs):
        c, n, m = state
        gt, ml, cl, nl = xs
        m_new = jnp.maximum(gt + m, ml)
        s_old = jnp.exp(gt + m - m_new)
        s_loc = jnp.exp(ml - m_new)
        c_new = s_old[..., None, None] * c + s_loc[..., None, None] * cl
        n_new = s_old[..., None] * n + s_loc[..., None] * nl
        return (c_new, n_new, m_new), (c, n, m)

    init = (jnp.zeros((B, H, D, D), jnp.float32), jnp.zeros((B, H, D), jnp.float32),
            jnp.full((B, H), NEG_INF, jnp.float32))
    xs = tuple(jnp.moveaxis(t, 2, 0) for t in (g_tot, m_loc, c_loc, n_loc))
    _, (c_prev, n_prev, m_prev) = lax.scan(carry_state, init, xs)
    c_prev = jnp.moveaxis(c_prev, 0, 2)
    n_prev = jnp.moveaxis(n_prev, 0, 2)
    m_prev = jnp.moveaxis(m_prev, 0, 2)

    causal = jnp.tril(jnp.ones((L, L), dtype=bool))
    d_intra = jnp.where(causal, g[..., :, None] - g[..., None, :] + ig[..., None, :], NEG_INF)
    inter = g + m_prev[..., None]
    m_row = jnp.maximum(inter, jnp.max(d_intra, axis=-1))
    w_intra = jnp.exp(d_intra - m_row[..., None])
    w_inter = jnp.exp(inter - m_row)
    s = jnp.einsum('bhcld,bhcsd->bhcls', q, k) * w_intra
    num = (jnp.einsum('bhcls,bhcsv->bhclv', s, v)
           + w_inter[..., None] * jnp.einsum('bhcvk,bhclk->bhclv', c_prev, q))
    den = jnp.sum(s, axis=-1) + w_inter * jnp.einsum('bhck,bhclk->bhcl', n_prev, q)
    h = num / jnp.maximum(jnp.abs(den), jnp.exp(-m_row))[..., None]
    return jnp.moveaxis(h, 1, 3).reshape(B, S, H, D)


def rwkv7_scan(r, decay, k, v, a_vec, b_vec):
    B, S, H, D = r.shape

    def step(state, xs):
        r_t, w_t, k_t, v_t, a_t, b_t = xs
        sa = jnp.einsum('bhvk,bhk->bhv', state, a_t)
        state = (state * w_t[:, :, None, :] + sa[..., None] * b_t[:, :, None, :]
                 + v_t[..., None] * k_t[:, :, None, :])
        return state, jnp.einsum('bhvk,bhk->bhv', state, r_t)

    xs = tuple(jnp.moveaxis(t, 1, 0) for t in (r, decay, k, v, a_vec, b_vec))
    _, y = lax.scan(step, jnp.zeros((B, H, D, D), jnp.float32), xs)
    return jnp.moveaxis(y, 0, 1)


def rwkv7_time_mix(u, mu, w0, w_up, a0, a_up, g_up, k_k, k_a, r_k, ln_w, ln_b):
    f32 = jnp.float32
    B, S, _ = u.shape
    u = u.astype(f32)
    prev = jnp.pad(u[:, :-1], ((0, 0), (1, 0), (0, 0)))
    u = u + (prev - u) * mu.astype(f32)
    r, k, v, xw, xa, xg = jnp.split(
        u, [RWKV_W, 2 * RWKV_W, 3 * RWKV_W, 3 * RWKV_W + RWKV_W_RANK,
            3 * RWKV_W + RWKV_W_RANK + RWKV_A_RANK], axis=-1)
    log_w = -jax.nn.softplus(-(w0.astype(f32) + jnp.tanh(xw) @ w_up.astype(f32))) - 0.5
    decay = jnp.exp(-jnp.exp(log_w))
    a = jax.nn.sigmoid(a0.astype(f32) + xa @ a_up.astype(f32))
    g = jax.nn.sigmoid(xg) @ g_up.astype(f32)

    def heads(t):
        return t.reshape(B, S, RWKV_HEADS, HEAD_DIM)

    kk = heads(k * k_k.astype(f32))
    kk = kk * lax.rsqrt(jnp.maximum(jnp.sum(kk * kk, axis=-1, keepdims=True), 1e-24))
    k = k * (1.0 + (a - 1.0) * k_a.astype(f32))
    r_h, k_h, v_h, a_h = heads(r), heads(k), heads(v), heads(a)
    y = rwkv7_scan(r_h, heads(decay), k_h, v_h, -kk, kk * a_h)
    mean = jnp.mean(y, axis=-1, keepdims=True)
    var = jnp.mean(jnp.square(y - mean), axis=-1, keepdims=True)
    y = ((y - mean) * lax.rsqrt(var + RWKV_GN_EPS) * ln_w.astype(f32).reshape(RWKV_HEADS, HEAD_DIM)
         + ln_b.astype(f32).reshape(RWKV_HEADS, HEAD_DIM))
    y = y + jnp.sum(r_h * k_h * r_k.astype(f32), axis=-1, keepdims=True) * v_h
    return y.reshape(B, S, RWKV_W) * g


def token_mixing(h, cos, sin, w_in, attn_sinks, mlstm_conv, mlstm_i_bias, mlstm_f_bias, mlstm_norm,
                 rwkv_mu, rwkv_w0, rwkv_w_up, rwkv_a0, rwkv_a_up, rwkv_g_up, rwkv_k_k, rwkv_k_a,
                 rwkv_r_k, rwkv_ln_w, rwkv_ln_b, w_out):
    f32 = jnp.float32
    B, S, _ = h.shape
    proj = h @ w_in
    attn_p, mlstm_p, rwkv_p = jnp.split(proj, [ATTN_COLS, ATTN_COLS + MLSTM_COLS], axis=-1)

    q_at, k_at, v_at = jnp.split(attn_p, [ATTN_W, ATTN_W + KV_W], axis=-1)
    q_at = partial_rope(q_at.reshape(B, S, ATTN_Q_HEADS, HEAD_DIM), cos, sin)
    k_at = partial_rope(k_at.reshape(B, S, ATTN_KV_HEADS, HEAD_DIM), cos, sin)
    v_at = v_at.reshape(B, S, ATTN_KV_HEADS, HEAD_DIM)
    y_attn = sliding_window_gqa(q_at, k_at, v_at, attn_sinks)

    qk_m, v_m, o_m, i_m, f_m = jnp.split(
        mlstm_p, [2 * MLSTM_W, 3 * MLSTM_W, 4 * MLSTM_W, 4 * MLSTM_W + MLSTM_HEADS], axis=-1)
    qk_m = jax.nn.silu(causal_depthwise_conv(qk_m, mlstm_conv))
    q_m, k_m = jnp.split(qk_m, 2, axis=-1)

    def m_heads(t):
        return t.astype(f32).reshape(B, S, MLSTM_HEADS, HEAD_DIM)

    i_pre = GATE_CAP * jnp.tanh((i_m.astype(f32) + mlstm_i_bias.astype(f32)) / GATE_CAP)
    f_pre = GATE_CAP * jnp.tanh((f_m.astype(f32) + mlstm_f_bias.astype(f32)) / GATE_CAP)
    h_m = mlstm_chunkwise(m_heads(q_m), m_heads(k_m), m_heads(v_m), i_pre, f_pre)
    h_m = (h_m * lax.rsqrt(jnp.mean(h_m * h_m, axis=-1, keepdims=True) + NORM_EPS)
           * mlstm_norm.astype(f32).reshape(MLSTM_HEADS, HEAD_DIM))
    y_mlstm = jax.nn.sigmoid(o_m.astype(f32)) * h_m.reshape(B, S, MLSTM_W)

    y_rwkv = rwkv7_time_mix(rwkv_p, rwkv_mu, rwkv_w0, rwkv_w_up, rwkv_a0, rwkv_a_up, rwkv_g_up,
                            rwkv_k_k, rwkv_k_a, rwkv_r_k, rwkv_ln_w, rwkv_ln_b)

    y = jnp.concatenate([y_attn, y_mlstm.astype(h.dtype), y_rwkv.astype(h.dtype)], axis=-1)
    return y @ w_out


def setup_inputs(seed: int = 0) -> dict:
    key = jax.random.key(seed)
    ks = iter(jax.random.split(key, 48))
    f32 = jnp.float32

    def normal(shape, scale):
        return scale * jax.random.normal(next(ks), shape, f32)

    def uniform(shape, lo, hi):
        return jax.random.uniform(next(ks), shape, f32, lo, hi)

    def gain(width):
        return 1.0 + normal((DEPTH, width), 0.05)

    x = normal((BATCH, SEQ, D_MODEL), 1.0)
    p = normal((DEPTH, BATCH, SEQ, D_PLE), 1.0)
    start = jax.random.randint(next(ks), (BATCH, 1), 0, 4096, jnp.int32)
    positions = start + jnp.arange(SEQ, dtype=jnp.int32)[None, :]
    return {
        'x': x,
        'p': p,
        'positions': positions,
        'ln_ffn1_pre': gain(D_MODEL),
        'ln_ffn1_post': gain(D_MODEL),
        'w_ffn1_in': normal((DEPTH, D_MODEL, 2 * D_FF), D_MODEL ** -0.5),
        'w_ffn1_out': normal((DEPTH, D_FF, D_MODEL), D_FF ** -0.5),
        'ln_mix_pre': gain(D_MODEL),
        'w_in': normal((DEPTH, D_MODEL, D_IN), D_MODEL ** -0.5),
        'attn_sinks': normal((DEPTH, ATTN_Q_HEADS), 0.5),
        'mlstm_conv': normal((DEPTH, MLSTM_CONV, 2 * MLSTM_W), MLSTM_CONV ** -0.5),
        'mlstm_i_bias': normal((DEPTH, MLSTM_HEADS), 0.1),
        'mlstm_f_bias': uniform((DEPTH, MLSTM_HEADS), 3.0, 6.0),
        'mlstm_norm': gain(MLSTM_W),
        'rwkv_mu': uniform((DEPTH, RWKV_COLS), 0.0, 1.0),
        'rwkv_w0': uniform((DEPTH, RWKV_W), -1.5, 0.5),
        'rwkv_w_up': normal((DEPTH, RWKV_W_RANK, RWKV_W), 0.1),
        'rwkv_a0': normal((DEPTH, RWKV_W), 0.1),
        'rwkv_a_up': normal((DEPTH, RWKV_A_RANK, RWKV_W), 0.5 * RWKV_A_RANK ** -0.5),
        'rwkv_g_up': normal((DEPTH, RWKV_G_RANK, RWKV_W), RWKV_G_RANK ** -0.5),
        'rwkv_k_k': 0.85 + normal((DEPTH, RWKV_W), 0.05),
        'rwkv_k_a': 1.0 + normal((DEPTH, RWKV_W), 0.05),
        'rwkv_r_k': normal((DEPTH, RWKV_HEADS, HEAD_DIM), 0.1),
        'rwkv_ln_w': gain(RWKV_W),
        'rwkv_ln_b': normal((DEPTH, RWKV_W), 0.01),
        'w_out': normal((DEPTH, D_MIX, D_MODEL), D_MIX ** -0.5),
        'ln_mix_post': gain(D_MODEL),
        'ln_ffn2_pre': gain(D_MODEL),
        'ln_ffn2_post': gain(D_MODEL),
        'w_ffn2_in': normal((DEPTH, D_MODEL, 2 * D_FF), D_MODEL ** -0.5),
        'w_ffn2_out': normal((DEPTH, D_FF, D_MODEL), D_FF ** -0.5),
        'ln_ple_pre': gain(D_MODEL),
        'w_ple_gate': normal((DEPTH, D_MODEL, D_MODEL), D_MODEL ** -0.5),
        'w_ple_proj': normal((DEPTH, D_PLE, D_MODEL), D_PLE ** -0.5),
        'ln_ple_post': gain(D_MODEL),
    }


def reference(x, p, positions, ln_ffn1_pre, ln_ffn1_post, w_ffn1_in, w_ffn1_out, ln_mix_pre, w_in,
              attn_sinks, mlstm_conv, mlstm_i_bias, mlstm_f_bias, mlstm_norm, rwkv_mu, rwkv_w0,
              rwkv_w_up, rwkv_a0, rwkv_a_up, rwkv_g_up, rwkv_k_k, rwkv_k_a, rwkv_r_k, rwkv_ln_w,
              rwkv_ln_b, w_out, ln_mix_post, ln_ffn2_pre, ln_ffn2_post, w_ffn2_in, w_ffn2_out,
              ln_ple_pre, w_ple_gate, w_ple_proj, ln_ple_post):
    cos, sin = rope_tables(positions)
    for l in range(DEPTH):
        x = x + 0.5 * rms_norm(swiglu(rms_norm(x, ln_ffn1_pre[l]), w_ffn1_in[l], w_ffn1_out[l]),
                               ln_ffn1_post[l])
        mix = token_mixing(rms_norm(x, ln_mix_pre[l]), cos, sin, w_in[l], attn_sinks[l],
                           mlstm_conv[l], mlstm_i_bias[l], mlstm_f_bias[l], mlstm_norm[l],
                           rwkv_mu[l], rwkv_w0[l], rwkv_w_up[l], rwkv_a0[l], rwkv_a_up[l],
                           rwkv_g_up[l], rwkv_k_k[l], rwkv_k_a[l], rwkv_r_k[l], rwkv_ln_w[l],
                           rwkv_ln_b[l], w_out[l])
        x = x + rms_norm(mix, ln_mix_post[l])
        x = x + 0.5 * rms_norm(swiglu(rms_norm(x, ln_ffn2_pre[l]), w_ffn2_in[l], w_ffn2_out[l]),
                               ln_ffn2_post[l])
        gate = jax.nn.sigmoid(rms_norm(x, ln_ple_pre[l]) @ w_ple_gate[l])
        x = x + rms_norm(gate * (p[l] @ w_ple_proj[l]), ln_ple_post[l])
    return x
```

```cpp
#include <hip/hip_runtime.h>
#include <cstdio>
#include <cstdint>
#define MK_PER_PHASE 1
namespace pg8 {
#define PG8_LAS __attribute__((address_space(3)))
typedef unsigned short bf16_t;
typedef short bf16x8 __attribute__((ext_vector_type(8)));
typedef float f32x4 __attribute__((ext_vector_type(4)));
typedef unsigned u32x4 __attribute__((ext_vector_type(4)));
constexpr int BM = 256, BK = 64, HALF = 128, HTB = HALF * BK * 2  , STAGE_BYTES = 8 * HTB, NXCD = 8, WGM = 8;

__host__ __device__ __forceinline__ int lds_byte(int r, int c) { const int st = (r >> 4) * 2 + (c >> 5), rr = r & 15, cc = c & 31, ob = rr * 64 + cc * 2; return st * 1024 + (ob ^ (((ob >> 9) & 1) << 5)); }
__host__ __device__ __forceinline__ void stage_rc(int b, int& R, int& C) { const int st = b / 1024, sb = b % 1024, swz = sb ^ (((sb >> 9) & 1) << 5); R = (st >> 1) * 16 + swz / 64; C = (st & 1) * 32 + (swz % 64) / 2; }
__host__ __device__ __forceinline__ int perm32(int rho) { const int n = rho >> 4, i = rho & 15; return 8 * (i >> 2) + 4 * n + (i & 3); }

struct Unit { int pm, pn; };
struct Gemm { const bf16_t* A; const bf16_t* Bt; int M, N, K; };

struct StaticOrder {
    int nM, nN, nwg, G, c;
    __host__ __device__ void init(int M, int N, int G_, int c_) { nM = M / BM; nN = N / BM; nwg = nM * nN; G = G_; c = c_; }
    __host__ __device__ bool next(int i, Unit& u) const {
        const long L = (long)i * G + c; if (L >= nwg) return false;
        int wgid = (int)L; { const int q = nwg / NXCD, r = nwg % NXCD, xcd = wgid % NXCD, off = wgid / NXCD; wgid = (xcd < r ? xcd * (q + 1) : r * (q + 1) + (xcd - r) * q) + off; }
        const int nig = WGM * nN, gid = wgid / nig, fm = gid * WGM, gsz = (nM - fm) < WGM ? (nM - fm) : WGM;
        u.pm = fm + ((wgid % nig) % gsz); u.pn = (wgid % nig) / gsz; return true;
    }
    __device__ __forceinline__ void a_ready(const Unit&) const {}
    __device__ __forceinline__ void done(const Unit&) const {}
};
__device__ __forceinline__ unsigned cvt_pk_bf16(float lo, float hi) { unsigned r; asm volatile("v_cvt_pk_bf16_f32 %0, %1, %2" : "=v"(r) : "v"(lo), "v"(hi)); return r; }
typedef float f32x2 __attribute__((ext_vector_type(2)));
template <class Epi, class Sched, bool ALIGN_EPI = false, bool SP2 = false>
__device__ __forceinline__ void gemm_phase(PG8_LAS unsigned char* lds, const Gemm g, const Sched& S, const Epi& E) {
    int tid_l = threadIdx.x; asm volatile("" : "+v"(tid_l));
    const int tid = tid_l, wid = __builtin_amdgcn_readfirstlane(tid >> 6), lane = tid & 63, wr = wid >> 2, wc = wid & 3, fr = lane & 15, fq = lane >> 4;
    const int K = g.K, nt = K / BK;
    unsigned voffA[2], voffB[2];
#pragma unroll
    for (int i = 0; i < 2; ++i) { int R, C; stage_rc(tid * 16 + i * 8192, R, C); const int Rb = Epi::PERM ? ((R & ~31) + perm32(R & 31)) : R;
        voffA[i] = (unsigned)(R * K + C) * 2u; voffB[i] = (unsigned)(Rb * K + C) * 2u; }
    const size_t kstep = (size_t)(BK * 2);
    const size_t hstep = (size_t)HALF * K * 2;
    const size_t tstep = 2 * hstep;
    const unsigned ldsw = (unsigned)wid * 1024u;
    const int aoff = lds_byte(wr * 64 + fr, fq * 8), boff = lds_byte(wc * 32 + fr, fq * 8);
#define PG8_SA(b, h) (((b) * 2 + (h)) * HTB)
#define PG8_SB(b, h) ((4 + (b) * 2 + (h)) * HTB)
#define PG8_STAGE(bufoff, gbase, voff) do { _Pragma("unroll") for (int _i = 0; _i < 2; ++_i) \
        __builtin_amdgcn_global_load_lds((const unsigned*)((const char*)(gbase) + (voff)[_i]), (PG8_LAS unsigned*)(lds + (bufoff) + ldsw + _i * 8192), 16, 0, 0); } while (0)
#define PG8_LDA(dst, b, h) do { _Pragma("unroll") for (int m = 0; m < 4; ++m) _Pragma("unroll") for (int k = 0; k < 2; ++k) dst[m][k] = *(const PG8_LAS bf16x8*)(lds + PG8_SA(b, h) + aoff + m * 2048 + k * 1024); } while (0)
#define PG8_LDB(dst, b, h) do { _Pragma("unroll") for (int n = 0; n < 2; ++n) _Pragma("unroll") for (int k = 0; k < 2; ++k) dst[n][k] = *(const PG8_LAS bf16x8*)(lds + PG8_SB(b, h) + boff + n * 2048 + k * 1024); } while (0)
#define PG8_MMA(ai, bj, At, Bt) do { __builtin_amdgcn_s_setprio(1); _Pragma("unroll") for (int m = 0; m < 4; ++m) _Pragma("unroll") for (int n = 0; n < 2; ++n) _Pragma("unroll") for (int k = 0; k < 2; ++k) \
        acc[ai][bj][m][n] = __builtin_amdgcn_mfma_f32_16x16x32_bf16(Bt[n][k], At[m][k], acc[ai][bj][m][n], 0, 0, 0); __builtin_amdgcn_s_setprio(0); } while (0)
#define PG8_WAIT_V(n) asm volatile("s_waitcnt vmcnt(" #n ")" ::: "memory")
#define PG8_WAIT_L(n) asm volatile("s_waitcnt lgkmcnt(" #n ")" ::: "memory")
#define PG8_BAR __builtin_amdgcn_s_barrier()
#define PG8_SCHED __builtin_amdgcn_sched_barrier(0)
    Unit cur, nxt; int ui = 0;
    if (!S.next(0, cur)) return;
    f32x4 acc[2][2][4][2];
#pragma unroll
    for (int a = 0; a < 2; ++a)
#pragma unroll
        for (int b = 0; b < 2; ++b)
#pragma unroll
            for (int m = 0; m < 4; ++m)
#pragma unroll
                for (int n = 0; n < 2; ++n) acc[a][b][m][n] = (f32x4){0.f, 0.f, 0.f, 0.f};
    bf16x8 At[4][2], B0[2][2], B1[2][2];
    const char* cA = (const char*)g.A + (size_t)cur.pm * tstep; const char* cB = (const char*)g.Bt + (size_t)cur.pn * tstep;
    S.a_ready(cur);
    if constexpr (SP2) {
        PG8_STAGE(PG8_SB(0, 0), cB, voffB); PG8_STAGE(PG8_SB(0, 1), cB + hstep, voffB); PG8_STAGE(PG8_SA(0, 0), cA, voffA); PG8_STAGE(PG8_SA(0, 1), cA + hstep, voffA);
        if (wr == 1) PG8_BAR;
        PG8_WAIT_V(2); PG8_BAR;
        PG8_STAGE(PG8_SB(1, 0), cB + kstep, voffB); PG8_STAGE(PG8_SA(1, 0), cA + kstep, voffA); PG8_STAGE(PG8_SB(1, 1), cB + hstep + kstep, voffB);
        PG8_WAIT_V(6); PG8_BAR;
    } else {
        PG8_STAGE(PG8_SB(0, 0), cB, voffB); PG8_STAGE(PG8_SA(0, 0), cA, voffA); PG8_STAGE(PG8_SB(0, 1), cB + hstep, voffB); PG8_STAGE(PG8_SA(0, 1), cA + hstep, voffA);
        if (wr == 1) PG8_BAR;
        PG8_WAIT_V(4); PG8_BAR;
        PG8_STAGE(PG8_SB(1, 0), cB + kstep, voffB); PG8_STAGE(PG8_SA(1, 0), cA + kstep, voffA); PG8_STAGE(PG8_SB(1, 1), cB + hstep + kstep, voffB);
        PG8_WAIT_V(6); PG8_BAR;
    }
    for (;;) {
        const bool has_next = S.next(ui + 1, nxt);
        const char* nA = has_next ? (const char*)g.A + (size_t)nxt.pm * tstep : cA; const char* nB = has_next ? (const char*)g.Bt + (size_t)nxt.pn * tstep : cB;
        for (int t = 0; t < nt; t += 2) {
            const bool last = (t == nt - 2);
            const char* a1 = cA + (size_t)(t + 1) * kstep;
            const char* a2 = last ? nA : cA + (size_t)(t + 2) * kstep; const char* b2 = last ? nB : cB + (size_t)(t + 2) * kstep;
            const char* a3 = a2 + kstep; const char* b3 = b2 + kstep;
            if (last && has_next) S.a_ready(nxt);
            if constexpr (SP2) {
            PG8_LDB(B0, 0, 0); PG8_LDB(B1, 0, 1); PG8_SCHED; PG8_LDA(At, 0, 0); PG8_STAGE(PG8_SA(1, 1), a1 + hstep, voffA);
            PG8_WAIT_V(8); PG8_WAIT_L(0); PG8_BAR; PG8_MMA(0, 0, At, B0); PG8_MMA(0, 1, At, B1); PG8_BAR; PG8_SCHED;
            PG8_LDA(At, 0, 1); PG8_STAGE(PG8_SB(0, 0), b2, voffB); PG8_STAGE(PG8_SB(0, 1), b2 + hstep, voffB); PG8_STAGE(PG8_SA(0, 0), a2, voffA);
            PG8_WAIT_V(8); PG8_WAIT_L(0); PG8_BAR; PG8_MMA(1, 0, At, B0); PG8_MMA(1, 1, At, B1); PG8_BAR; PG8_SCHED;
            PG8_LDB(B0, 1, 0); PG8_LDB(B1, 1, 1); PG8_SCHED; PG8_LDA(At, 1, 0); PG8_STAGE(PG8_SA(0, 1), a2 + hstep, voffA);
            PG8_WAIT_V(8); PG8_WAIT_L(0); PG8_BAR; PG8_MMA(0, 0, At, B0); PG8_MMA(0, 1, At, B1); PG8_BAR; PG8_SCHED;
            PG8_LDA(At, 1, 1); PG8_STAGE(PG8_SB(1, 0), b3, voffB); PG8_STAGE(PG8_SB(1, 1), b3 + hstep, voffB); PG8_STAGE(PG8_SA(1, 0), a3, voffA);
            PG8_WAIT_V(8); PG8_WAIT_L(0); PG8_BAR; PG8_MMA(1, 0, At, B0); PG8_MMA(1, 1, At, B1); PG8_BAR; PG8_SCHED;
            } else {
            PG8_LDB(B0, 0, 0); PG8_SCHED; PG8_LDA(At, 0, 0); PG8_STAGE(PG8_SA(1, 1), a1 + hstep, voffA);
            PG8_WAIT_L(8); PG8_BAR; PG8_WAIT_L(0); PG8_MMA(0, 0, At, B0); PG8_BAR; PG8_SCHED;
            PG8_LDB(B1, 0, 1); PG8_STAGE(PG8_SB(0, 0), b2, voffB);
            PG8_BAR; PG8_WAIT_L(0); PG8_MMA(0, 1, At, B1); PG8_BAR;
            PG8_LDA(At, 0, 1); PG8_STAGE(PG8_SA(0, 0), a2, voffA);
            PG8_BAR; PG8_WAIT_L(0); PG8_MMA(1, 0, At, B0); PG8_BAR; PG8_SCHED;
            PG8_STAGE(PG8_SB(0, 1), b2 + hstep, voffB);
            PG8_WAIT_V(6); PG8_BAR; PG8_MMA(1, 1, At, B1); PG8_BAR;
            PG8_LDB(B0, 1, 0); PG8_SCHED; PG8_LDA(At, 1, 0); PG8_STAGE(PG8_SA(0, 1), a2 + hstep, voffA);
            PG8_WAIT_L(8); PG8_BAR; PG8_WAIT_L(0); PG8_MMA(0, 0, At, B0); PG8_BAR; PG8_SCHED;
            PG8_LDB(B1, 1, 1); PG8_STAGE(PG8_SB(1, 0), b3, voffB);
            PG8_BAR; PG8_WAIT_L(0); PG8_MMA(0, 1, At, B1); PG8_BAR;
            PG8_LDA(At, 1, 1); PG8_STAGE(PG8_SA(1, 0), a3, voffA);
            PG8_BAR; PG8_WAIT_L(0); PG8_MMA(1, 0, At, B0); PG8_BAR; PG8_SCHED;
            PG8_STAGE(PG8_SB(1, 1), b3 + hstep, voffB);
            PG8_WAIT_V(6); PG8_BAR; PG8_MMA(1, 1, At, B1); PG8_BAR;
            }
        }
        if constexpr (ALIGN_EPI) { if (wr == 0) PG8_BAR; }
        if constexpr (!Epi::AFTER_DRAIN) { E(acc, cur, wr, wc, fr, fq); S.done(cur); }
        if (!has_next) break;
#pragma unroll
        for (int a = 0; a < 2; ++a)
#pragma unroll
            for (int b = 0; b < 2; ++b)
#pragma unroll
                for (int m = 0; m < 4; ++m)
#pragma unroll
                    for (int n = 0; n < 2; ++n) acc[a][b][m][n] = (f32x4){0.f, 0.f, 0.f, 0.f};
        cur = nxt; cA = nA; cB = nB; ++ui;
        if constexpr (ALIGN_EPI) { if (wr == 1) PG8_BAR; }
    }
    PG8_WAIT_V(0);
    if constexpr (!ALIGN_EPI) { if (wr == 0) PG8_BAR; }
    PG8_BAR;
    if constexpr (Epi::AFTER_DRAIN) { E.fused(acc, cur, wr, wc, fr, fq, lds, wid, lane); S.done(cur); }
#undef PG8_SA
#undef PG8_SB
#undef PG8_STAGE
#undef PG8_LDA
#undef PG8_LDB
#undef PG8_MMA
#undef PG8_WAIT_V
#undef PG8_WAIT_L
#undef PG8_BAR
#undef PG8_SCHED
}
}
constexpr int M = 16384, D = 1024, FF = 2816, NFF2 = 2 * FF, DIN = 2824, DINP = 3072, LDP = 2832, DPLE = 256, DEPTH = 2;
constexpr int NWAVES = 8, NTHR = 512;
constexpr float NORM_EPS = 1e-6f;
constexpr int PC_Q = 0, PC_K = 512, PC_V = 640, PC_MQ = 768, PC_MK = 1024, PC_MV = 1280, PC_MO = 1536, PC_MI = 1792, PC_MF = 1796;
constexpr int PC_R = 1800, PC_RR = 1800, PC_RK = 2056, PC_RV = 2312, PC_RW = 2568, PC_RA = 2632, PC_RG = 2696;
enum { I_X = 0, I_P, I_POS, I_LN_F1PRE, I_LN_F1POST, I_W_F1IN, I_W_F1OUT, I_LN_MIXPRE, I_W_IN, I_SINKS, I_MCONV, I_MIB, I_MFB, I_MNORM,
       I_RMU, I_RW0, I_RWUP, I_RA0, I_RAUP, I_RGUP, I_RKK, I_RKA, I_RRK, I_RLNW, I_RLNB, I_W_OUT, I_LN_MIXPOST, I_LN_F2PRE, I_LN_F2POST,
       I_W_F2IN, I_W_F2OUT, I_LN_PLEPRE, I_W_PLEG, I_W_PLEP, I_LN_PLEPOST, N_IN };

namespace pg8 {
typedef unsigned u32x2 __attribute__((ext_vector_type(2)));
__device__ __forceinline__ float bfu(unsigned short b) { return __builtin_bit_cast(float, (unsigned)b << 16); }
__device__ __forceinline__ float sigmoidf_(float x) { return 1.0f / (1.0f + __expf(-x)); }
struct EpiSwiglu {
    static constexpr bool PERM = true, AFTER_DRAIN = false;
    bf16_t* H; int ldc;
    __device__ __forceinline__ void operator()(const f32x4 (&acc)[2][2][4][2], const Unit& u, int wr, int wc, int fr, int fq) const {
        const int row0 = u.pm * BM + wr * 64 + fr, col0 = u.pn * HALF + wc * 32 + 8 * fq;
#pragma unroll
        for (int ai = 0; ai < 2; ++ai)
#pragma unroll
            for (int m = 0; m < 4; ++m) {
                bf16_t* rowp = H + (size_t)(row0 + ai * HALF + m * 16) * ldc + col0;
                float o[8];
#pragma unroll
                for (int n = 0; n < 2; ++n)
#pragma unroll
                    for (int j = 0; j < 4; ++j) { const float g = acc[ai][0][m][n][j], up = acc[ai][1][m][n][j]; o[n * 4 + j] = g * sigmoidf_(g) * up; }
                u32x4 w; w.x = cvt_pk_bf16(o[0], o[1]); w.y = cvt_pk_bf16(o[2], o[3]); w.z = cvt_pk_bf16(o[4], o[5]); w.w = cvt_pk_bf16(o[6], o[7]);
                *(u32x4*)rowp = w;
            }
    }
};
struct EpiBf16G {
    static constexpr bool PERM = true, AFTER_DRAIN = false;
    bf16_t* O; int ldc; int ncols;
    __device__ __forceinline__ void operator()(const f32x4 (&acc)[2][2][4][2], const Unit& u, int wr, int wc, int fr, int fq) const {
        const int row0 = u.pm * BM + wr * 64 + fr, col0 = u.pn * BM + wc * 32 + 8 * fq;
#pragma unroll
        for (int ai = 0; ai < 2; ++ai)
#pragma unroll
            for (int m = 0; m < 4; ++m) {
                bf16_t* rowp = O + (size_t)(row0 + ai * HALF + m * 16) * ldc + col0;
#pragma unroll
                for (int bj = 0; bj < 2; ++bj) {
                    if (col0 + bj * HALF < ncols) {
                        const f32x4 v0 = acc[ai][bj][m][0], v1 = acc[ai][bj][m][1];
                        u32x4 w; w.x = cvt_pk_bf16(v0[0], v0[1]); w.y = cvt_pk_bf16(v0[2], v0[3]); w.z = cvt_pk_bf16(v1[0], v1[1]); w.w = cvt_pk_bf16(v1[2], v1[3]);
                        *(u32x4*)(rowp + bj * HALF) = w;
                    }
                }
            }
    }
};
struct EpiPle {
    static constexpr bool PERM = true, AFTER_DRAIN = false;
    bf16_t* O; const bf16_t* PP; int ldc;
    __device__ __forceinline__ void operator()(const f32x4 (&acc)[2][2][4][2], const Unit& u, int wr, int wc, int fr, int fq) const {
        const int row0 = u.pm * BM + wr * 64 + fr, col0 = u.pn * BM + wc * 32 + 8 * fq;
#pragma unroll
        for (int ai = 0; ai < 2; ++ai)
#pragma unroll
            for (int m = 0; m < 4; ++m) {
                const size_t off = (size_t)(row0 + ai * HALF + m * 16) * ldc + col0;
#pragma unroll
                for (int bj = 0; bj < 2; ++bj) {
                    const u32x4 pv = *(const u32x4*)(PP + off + bj * HALF);
                    const f32x4 v0 = acc[ai][bj][m][0], v1 = acc[ai][bj][m][1];
                    float o[8];
                    o[0] = sigmoidf_(v0[0]) * bfu((unsigned short)(pv.x & 0xffff)); o[1] = sigmoidf_(v0[1]) * bfu((unsigned short)(pv.x >> 16));
                    o[2] = sigmoidf_(v0[2]) * bfu((unsigned short)(pv.y & 0xffff)); o[3] = sigmoidf_(v0[3]) * bfu((unsigned short)(pv.y >> 16));
                    o[4] = sigmoidf_(v1[0]) * bfu((unsigned short)(pv.z & 0xffff)); o[5] = sigmoidf_(v1[1]) * bfu((unsigned short)(pv.z >> 16));
                    o[6] = sigmoidf_(v1[2]) * bfu((unsigned short)(pv.w & 0xffff)); o[7] = sigmoidf_(v1[3]) * bfu((unsigned short)(pv.w >> 16));
                    u32x4 w; w.x = cvt_pk_bf16(o[0], o[1]); w.y = cvt_pk_bf16(o[2], o[3]); w.z = cvt_pk_bf16(o[4], o[5]); w.w = cvt_pk_bf16(o[6], o[7]);
                    *(u32x4*)(O + off + bj * HALF) = w;
                }
            }
    }
};
}

constexpr size_t MiB = 1u << 20, KiB = 1u << 10;
constexpr size_t WS_CTL = 0, CTL_ZERO_BYTES = 1 * MiB;
constexpr size_t WS_W1A = 1 * MiB;
constexpr size_t WS_W1B = 12 * MiB;
constexpr size_t WS_WIN = WS_W1B + 5632 * KiB;
constexpr size_t WS_WOUT = WS_WIN + 6 * MiB;
constexpr size_t WS_W2A = WS_WOUT + 2 * MiB;
constexpr size_t WS_W2B = WS_W2A + 11 * MiB;
constexpr size_t WS_WG = WS_W2B + 5632 * KiB;
constexpr size_t WS_WP = WS_WG + 2 * MiB;
constexpr size_t WS_ROPE = 45 * MiB;
static_assert(WS_WP + 512 * KiB <= WS_ROPE, "weights");
constexpr size_t WS_XN = 46 * MiB;
constexpr size_t WS_Y = 78 * MiB;
constexpr size_t WS_PP = 110 * MiB;
constexpr size_t WS_YMIX = 142 * MiB;
constexpr size_t WS_HP = 174 * MiB;
constexpr size_t WS_TAIL = WS_HP + (size_t)M * LDP * 2;
constexpr size_t T_IG = WS_TAIL, T_GC = T_IG + 256 * KiB, T_NLOC = T_GC + 256 * KiB, T_NPREV = T_NLOC + 256 * KiB, T_BONUS = T_NPREV + 256 * KiB,
                 T_MLOC = T_BONUS + 256 * KiB, T_GTOT = T_MLOC + 4 * KiB, T_MPREV = T_GTOT + 4 * KiB, WS_END = T_MPREV + 4 * KiB;
static_assert(WS_END <= 268 * MiB, "workspace");
constexpr size_t SCR_QKC = 46 * MiB;
constexpr size_t SCR_CLOC = 62 * MiB;
constexpr size_t SCR_CPREV = 78 * MiB;
constexpr size_t SCR_YT = 86 * MiB;
constexpr size_t SCR_PT = 102 * MiB;
constexpr size_t SCR_UC = 110 * MiB;
constexpr size_t SCR_PTC = 126 * MiB;
constexpr size_t SCR_SC = 134 * MiB;
static_assert(SCR_SC + 8 * MiB <= WS_YMIX, "scratch");
constexpr int CW_TMO = 0, CW_CODE = 1, CW_BAR = 4096;
#define GAS __attribute__((address_space(1)))
#define LAS __attribute__((address_space(3)))
typedef unsigned short bf16;
typedef unsigned v4u __attribute__((ext_vector_type(4)));
typedef float f32x4 __attribute__((ext_vector_type(4)));
typedef short bf16x8 __attribute__((ext_vector_type(8)));
typedef GAS unsigned gu32;
typedef GAS unsigned long long gu64;
#define RLX_AGENT __ATOMIC_RELAXED, __HIP_MEMORY_SCOPE_AGENT
#define LDS_WAIT() asm volatile("s_waitcnt lgkmcnt(0)" ::: "memory")
#define VM_WAIT() asm volatile("s_waitcnt vmcnt(0)" ::: "memory")
__device__ __forceinline__ unsigned long long rt() { return __builtin_amdgcn_s_memrealtime(); }
__device__ __forceinline__ unsigned f2bf(float f) { unsigned u = __builtin_bit_cast(unsigned, f); return (u + 0x7fffu + ((u >> 16) & 1u)) >> 16; }
__device__ __forceinline__ unsigned pk2(float lo, float hi) { return f2bf(lo) | (f2bf(hi) << 16); }

#define XB_TMO      128
#define XB_XCNT(j)  (256  + 64 * (j))
#define XB_XSUB(j)  (1280 + 64 * (j))
#define XB_XGEN(j)  (2304 + 64 * (j))
#define XB_TOP      3328
#define XB_TOPGEN   3392
#define XCD_BAR_WORDS 3456
#define XB_SPIN_CAP (1u << 18)

__device__ __forceinline__ unsigned xb_ld(unsigned* p)              { return __hip_atomic_load(p, __ATOMIC_RELAXED, __HIP_MEMORY_SCOPE_AGENT); }
__device__ __forceinline__ unsigned xb_add(unsigned* p, unsigned v) { return __hip_atomic_fetch_add(p, v, __ATOMIC_RELAXED, __HIP_MEMORY_SCOPE_AGENT); }
__device__ __forceinline__ unsigned xb_xcc_id() { return (unsigned)__builtin_amdgcn_s_getreg((3 << 11) | 20) & 0xFu; }
#define XB_SPIN(cond, bar) do { unsigned _sp = 0; while (cond) { __builtin_amdgcn_s_sleep(1); \
    if ((++_sp & 255u) == 0u) { if (xb_ld(&(bar)[XB_TMO])) break; if (_sp > XB_SPIN_CAP) { atomicAdd(&(bar)[XB_TMO], 1u); break; } } } } while (0)

struct XcdBarrier {
    unsigned* bar; unsigned x;
    volatile LAS unsigned* st;
};

__device__ __forceinline__ XcdBarrier xcd_barrier_post(unsigned* bar, volatile LAS unsigned* st) {
    XcdBarrier b; b.bar = bar; b.x = xb_xcc_id(); b.st = st;
    if (threadIdx.x == 0) (void)xb_add(&bar[XB_XCNT(b.x)], 1u);
    return b;
}
__device__ __forceinline__ void xcd_barrier_complete(unsigned* bar, unsigned x, unsigned& nloc, unsigned& nx) {
    const unsigned G = gridDim.x * gridDim.y * gridDim.z;
    unsigned sum, cnt, mine, sp = 0u;
    for (;;) {
        sum = 0u; cnt = 0u; mine = 0u;
#pragma unroll
        for (unsigned j = 0; j < 16; ++j) { const unsigned c = xb_ld(&bar[XB_XCNT(j)]); sum += c; cnt += (c > 0u) ? 1u : 0u; mine = (j == x) ? c : mine; }
        if (sum == G) break;
        __builtin_amdgcn_s_sleep(1);
        if ((++sp & 255u) == 0u) { if (xb_ld(&bar[XB_TMO])) break; if (sp > XB_SPIN_CAP) { atomicAdd(&bar[XB_TMO], 1u); break; } }
    }
    nloc = mine > 0u ? mine : 1u; nx = cnt > 0u ? cnt : 1u;
}

__device__ __forceinline__ void xcd_barrier(const XcdBarrier& b) {
    asm volatile("s_waitcnt vmcnt(0)" ::: "memory");
    __syncthreads();
    if (threadIdx.x == 0) {
        unsigned* bar = b.bar;
        __builtin_amdgcn_s_waitcnt(0);
        unsigned nloc = b.st[0], nx = b.st[1];
        if (nloc == 0u) { xcd_barrier_complete(bar, b.x, nloc, nx); b.st[0] = nloc; b.st[1] = nx; }
        const unsigned old = xb_add(&bar[XB_XSUB(b.x)], 1u);
        const unsigned gen = old / nloc;
        if (old + 1u == (gen + 1u) * nloc) {
            __builtin_amdgcn_fence(__ATOMIC_RELEASE, "agent");
            asm volatile("s_waitcnt vmcnt(0)" ::: "memory");
            const unsigned og = xb_add(&bar[XB_TOP], 1u);
            const unsigned tg = og / nx;
            if (og + 1u == (tg + 1u) * nx) xb_add(&bar[XB_TOPGEN], 1u);
            else XB_SPIN(xb_ld(&bar[XB_TOPGEN]) == tg, bar);
            __builtin_amdgcn_fence(__ATOMIC_ACQUIRE, "agent");
            xb_add(&bar[XB_XGEN(b.x)], 1u);
            asm volatile("s_waitcnt vmcnt(0)" ::: "memory");
        } else {
            XB_SPIN(xb_ld(&bar[XB_XGEN(b.x)]) == gen, bar);
            __builtin_amdgcn_fence(__ATOMIC_ACQUIRE, "agent");
            asm volatile("s_waitcnt vmcnt(0)" ::: "memory");
        }
    }
    __syncthreads();
}
typedef const float* cfp_t;
typedef const __attribute__((address_space(4))) cfp_t* kargp;
struct Frame {
    LAS unsigned char* lds;
    volatile LAS unsigned* MISC;
    gu32* ctl;
    int tid, lane, wave, G, bid;
    kargp in;
    float* out;
    unsigned char* ws;
};
__device__ __forceinline__ float bf2f(unsigned short b) { return __builtin_bit_cast(float, (unsigned)b << 16); }
__device__ __forceinline__ float wave_sum(float v) {
#pragma unroll
    for (int o = 1; o < 64; o <<= 1) v += __shfl_xor(v, o);
    return v;
}
__device__ __forceinline__ float sigm(float x) { return 1.0f / (1.0f + __expf(-x)); }
typedef unsigned u32x2v __attribute__((ext_vector_type(2)));
__device__ __forceinline__ f32x4 mma16(const LAS bf16* A, int lda, const LAS bf16* Bt, int ldb, int K, f32x4 acc, int lane) {
    const LAS bf16* ap = A + (lane & 15) * lda + 8 * (lane >> 4);
    const LAS bf16* bp = Bt + (lane & 15) * ldb + 8 * (lane >> 4);
    for (int k = 0; k < K; k += 32) {
        const bf16x8 a = *(const LAS bf16x8*)(ap + k), b = *(const LAS bf16x8*)(bp + k);
        acc = __builtin_amdgcn_mfma_f32_16x16x32_bf16(a, b, acc, 0, 0, 0);
    }
    return acc;
}

__device__ __forceinline__ void conv_item(const float* W, int K, int N, bf16* WT, int k0, int n0, int drow0, LAS float* scr, int lane) {
    const int n = n0 + (lane & 31); const bool ok = n < N;
#pragma unroll 8
    for (int i = 0; i < 32; ++i) { const int kk = 2 * i + (lane >> 5); scr[kk * 33 + (lane & 31)] = ok ? W[(size_t)(k0 + kk) * N + n] : 0.f; }
    LDS_WAIT(); asm volatile("" ::: "memory");
    const int c = lane & 7;
#pragma unroll
    for (int j = 0; j < 4; ++j) { const int nn = (lane >> 3) + 8 * j; const LAS float* s = scr + (8 * c) * 33 + nn;
        v4u o; o.x = pk2(s[0 * 33], s[1 * 33]); o.y = pk2(s[2 * 33], s[3 * 33]); o.z = pk2(s[4 * 33], s[5 * 33]); o.w = pk2(s[6 * 33], s[7 * 33]);
        *(GAS v4u*)(WT + (size_t)(drow0 + nn) * K + k0 + 8 * c) = o; }
    LDS_WAIT(); asm volatile("" ::: "memory");
}
__device__ __forceinline__ int swiglu_row(int n0) { const int up = n0 >= FF ? 1 : 0, j = n0 - up * FF; return 256 * (j >> 7) + 128 * up + (j & 127); }
__device__ __forceinline__ void conv_weights(Frame& F, int L) {
    LAS float* scr = (LAS float*)(F.lds + F.wave * 16384);
    const int gw = F.bid * NWAVES + F.wave, NGW = F.G * NWAVES;
    unsigned char* ws = F.ws;
    const float* src[8] = { F.in[I_W_F1IN] + (size_t)L * D * NFF2, F.in[I_W_F1OUT] + (size_t)L * FF * D, F.in[I_W_IN] + (size_t)L * D * DIN, F.in[I_W_OUT] + (size_t)L * D * D,
                            F.in[I_W_F2IN] + (size_t)L * D * NFF2, F.in[I_W_F2OUT] + (size_t)L * FF * D, F.in[I_W_PLEG] + (size_t)L * D * D, F.in[I_W_PLEP] + (size_t)L * DPLE * D };
    const size_t dsto[8] = { WS_W1A, WS_W1B, WS_WIN, WS_WOUT, WS_W2A, WS_W2B, WS_WG, WS_WP };
    const int Ks[8] = { D, FF, D, D, D, FF, D, DPLE }, Ns[8] = { NFF2, D, DIN, D, NFF2, D, D, D };
    int base = 0;
#pragma unroll
    for (int mi = 0; mi < 8; ++mi) {
        const int K = Ks[mi], N = Ns[mi], nblk = (N + 31) / 32, items = (K / 64) * nblk;
        int it = gw - (base % NGW); if (it < 0) it += NGW;
        for (; it < items; it += NGW) {
            const int kb = it / nblk, nb = it % nblk, n0 = 32 * nb;
            const int drow = (mi == 0 || mi == 4) ? swiglu_row(n0) : n0;
            conv_item(src[mi], K, N, (bf16*)(ws + dsto[mi]), 64 * kb, n0, drow, scr, F.lane);
        }
        base += items;
    }
    { v4u z = {0u, 0u, 0u, 0u}; GAS v4u* p = (GAS v4u*)(ws + WS_WIN + (size_t)2848 * D * 2); const int n16 = (DINP - 2848) * D * 2 / 16;
      for (int i = F.bid * NTHR + F.tid; i < n16; i += F.G * NTHR) p[i] = z; }
}

__device__ __forceinline__ void row_phase(Frame& F, const float* xsrc, const bf16* Y, float coef, const float* gpost, const float* gpre, float* xdst, bf16* XN) {
    const int gw = F.bid * NWAVES + F.wave, NGW = F.G * NWAVES, lane = F.lane;
    for (int m = gw; m < M; m += NGW) {
        const GAS f32x4* xr = (const GAS f32x4*)(xsrc + (size_t)m * D) + lane;
        f32x4 x[4];
#pragma unroll
        for (int j = 0; j < 4; ++j) x[j] = xr[64 * j];
        if (Y) {
            const GAS u32x2v* yr = (const GAS u32x2v*)(Y + (size_t)m * D) + lane;
            f32x4 y[4]; float ss = 0.f;
#pragma unroll
            for (int j = 0; j < 4; ++j) { const u32x2v w = yr[64 * j];
                y[j][0] = bf2f((unsigned short)(w.x & 0xffff)); y[j][1] = bf2f((unsigned short)(w.x >> 16)); y[j][2] = bf2f((unsigned short)(w.y & 0xffff)); y[j][3] = bf2f((unsigned short)(w.y >> 16));
                ss += (y[j][0] * y[j][0] + y[j][1] * y[j][1]) + (y[j][2] * y[j][2] + y[j][3] * y[j][3]); }
            const float rs = coef * rsqrtf(wave_sum(ss) * (1.f / D) + NORM_EPS);
#pragma unroll
            for (int j = 0; j < 4; ++j) { const f32x4 g = *((const GAS f32x4*)gpost + lane + 64 * j); x[j] = x[j] + y[j] * g * rs; }
        }
        GAS f32x4* xo = (GAS f32x4*)(xdst + (size_t)m * D) + lane;
#pragma unroll
        for (int j = 0; j < 4; ++j) xo[64 * j] = x[j];
        if (gpre) {
            float s2 = 0.f;
#pragma unroll
            for (int j = 0; j < 4; ++j) s2 += (x[j][0] * x[j][0] + x[j][1] * x[j][1]) + (x[j][2] * x[j][2] + x[j][3] * x[j][3]);
            const float r2 = rsqrtf(wave_sum(s2) * (1.f / D) + NORM_EPS);
            GAS u32x2v* o8 = (GAS u32x2v*)(XN + (size_t)m * D) + lane;
#pragma unroll
            for (int j = 0; j < 4; ++j) { const f32x4 g = *((const GAS f32x4*)gpre + lane + 64 * j); const f32x4 v = x[j] * g * r2;
                u32x2v w; w.x = pk2(v[0], v[1]); w.y = pk2(v[2], v[3]); o8[64 * j] = w; }
        }
    }
}

__device__ __forceinline__ void rope_table(Frame& F) {
    float* tab = (float*)(F.ws + WS_ROPE); const int* pos = (const int*)F.in[I_POS];
    for (int i = F.bid * NTHR + F.tid; i < M * 8; i += F.G * NTHR) {
        const int t = i >> 3, j = i & 7;
        const float inv = (float)pow(500000.0, -(double)(2 * j) / 16.0);
        const float ang = (float)pos[t] * inv;
        tab[t * 16 + j] = (float)cos((double)ang); tab[t * 16 + 8 + j] = (float)sin((double)ang);
    }
}
__device__ __forceinline__ void conv_p(Frame& F, int L, bf16* dst) {
    const GAS f32x4* src = (const GAS f32x4*)(F.in[I_P] + (size_t)L * M * DPLE);
    GAS u32x2v* o = (GAS u32x2v*)dst;
    for (int i = F.bid * NTHR + F.tid; i < M * DPLE / 4; i += F.G * NTHR) { const f32x4 v = src[i]; u32x2v w; w.x = pk2(v[0], v[1]); w.y = pk2(v[2], v[3]); o[i] = w; }
}

__device__ __forceinline__ void rope_inplace(Frame& F) {
    bf16* P = (bf16*)(F.ws + WS_HP); const float* tab = (const float*)(F.ws + WS_ROPE);
    for (int i = F.bid * NTHR + F.tid; i < M * 10; i += F.G * NTHR) {
        const int t = i / 10, hh = i % 10, col = hh < 8 ? 64 * hh : PC_K + 64 * (hh - 8);
        GAS v4u* p = (GAS v4u*)(P + (size_t)t * LDP + col);
        v4u a = p[0], b = p[1];
        const float* cs = tab + t * 16;
        unsigned aw[4] = {a.x, a.y, a.z, a.w}, bw[4] = {b.x, b.y, b.z, b.w};
#pragma unroll
        for (int j = 0; j < 4; ++j) {
            const float x1l = bf2f((unsigned short)(aw[j] & 0xffff)), x1h = bf2f((unsigned short)(aw[j] >> 16));
            const float x2l = bf2f((unsigned short)(bw[j] & 0xffff)), x2h = bf2f((unsigned short)(bw[j] >> 16));
            const float cl = cs[2 * j], ch = cs[2 * j + 1], sl = cs[8 + 2 * j], sh = cs[8 + 2 * j + 1];
            aw[j] = pk2(x1l * cl - x2l * sl, x1h * ch - x2h * sh);
            bw[j] = pk2(x2l * cl + x1l * sl, x2h * ch + x1h * sh);
        }
        a.x = aw[0]; a.y = aw[1]; a.z = aw[2]; a.w = aw[3]; b.x = bw[0]; b.y = bw[1]; b.z = bw[2]; b.w = bw[3];
        p[0] = a; p[1] = b;
    }
}

__device__ __forceinline__ void mlstm_local(Frame& F, int L, int h, int c) {
    const int tid = F.tid, lane = F.lane, wave = F.wave, t0 = 64 * c;
    const bf16* P = (const bf16*)(F.ws + WS_HP);
    LAS bf16* Ks = (LAS bf16*)(F.lds); LAS bf16* KT = (LAS bf16*)(F.lds + 9216); LAS bf16* VT = (LAS bf16*)(F.lds + 18432);
    LAS float* fw = (LAS float*)(F.lds + 27648);
    bf16* QKC = (bf16*)(F.ws + SCR_QKC);
    const float* cw = F.in[I_MCONV] + (size_t)L * 4 * 512;
    for (int e = tid; e < 64 * 128; e += NTHR) {
        const int l = e >> 7, ch = e & 127, isk = ch >> 6, j = ch & 63, cc = isk * 256 + 64 * h + j, col = PC_MQ + cc, t = t0 + l;
        float s = 0.f;
#pragma unroll
        for (int jj = 0; jj < 4; ++jj) { const int tt = t - 3 + jj; if (tt >= 0) s += cw[jj * 512 + cc] * bf2f(P[(size_t)tt * LDP + col]); }
        float v = s * sigm(s); if (!isk) v *= 0.125f;
        const bf16 vb = (bf16)f2bf(v);
        QKC[(size_t)t * 512 + cc] = vb;
        if (isk) { Ks[l * 72 + j] = vb; KT[j * 72 + l] = vb; }
    }
    if (wave == 0) {
        const int t = t0 + lane;
        const float im = bf2f(P[(size_t)t * LDP + PC_MI + h]) + F.in[I_MIB][L * 4 + h], fm = bf2f(P[(size_t)t * LDP + PC_MF + h]) + F.in[I_MFB][L * 4 + h];
        const float ip = 15.f * tanhf(im * (1.f / 15.f)), fp = 15.f * tanhf(fm * (1.f / 15.f));
        const float lf = fminf(fp, 0.f) - log1pf(__expf(-fabsf(fp)));
        float g = lf;
#pragma unroll
        for (int o = 1; o < 64; o <<= 1) { const float u = __shfl_up(g, o); if (lane >= o) g += u; }
        const float gt = __shfl(g, 63);
        const float a = gt - g + ip;
        float mx = a;
#pragma unroll
        for (int o = 1; o < 64; o <<= 1) mx = fmaxf(mx, __shfl_xor(mx, o));
        fw[lane] = __expf(a - mx);
        ((float*)(F.ws + T_IG))[t * 4 + h] = ip; ((float*)(F.ws + T_GC))[t * 4 + h] = g;
        if (lane == 0) { ((float*)(F.ws + T_MLOC))[h * 256 + c] = mx; ((float*)(F.ws + T_GTOT))[h * 256 + c] = gt; }
    }
    __syncthreads();
    for (int e = tid; e < 64 * 64; e += NTHR) { const int l = e >> 6, v = e & 63; VT[v * 72 + l] = (bf16)f2bf(fw[l] * bf2f(P[(size_t)(t0 + l) * LDP + PC_MV + 64 * h + v])); }
    if (tid < 64) { float s = 0.f; for (int l = 0; l < 64; ++l) s += fw[l] * bf2f(Ks[l * 72 + tid]); ((float*)(F.ws + T_NLOC))[(h * 256 + c) * 64 + tid] = s; }
    __syncthreads();
    float* CL = (float*)(F.ws + SCR_CLOC) + (size_t)(h * 256 + c) * 4096;
#pragma unroll
    for (int i = 0; i < 2; ++i) { const int tix = wave * 2 + i, mi = tix >> 2, ni = tix & 3;
        f32x4 acc = {0.f, 0.f, 0.f, 0.f}; acc = mma16(VT + 16 * mi * 72, 72, KT + 16 * ni * 72, 72, 64, acc, lane);
#pragma unroll
        for (int r = 0; r < 4; ++r) CL[(16 * mi + 4 * (lane >> 4) + r) * 64 + 16 * ni + (lane & 15)] = acc[r]; }
    __syncthreads();
}
__device__ __forceinline__ void mlstm_scan(Frame& F, int h) {
    const int tid = F.tid;
    const float* CL = (const float*)(F.ws + SCR_CLOC) + (size_t)h * 256 * 4096; bf16* CP = (bf16*)(F.ws + SCR_CPREV) + (size_t)h * 256 * 4096;
    const float* NL = (const float*)(F.ws + T_NLOC) + h * 256 * 64; float* NP = (float*)(F.ws + T_NPREV) + h * 256 * 64;
    const float* ML = (const float*)(F.ws + T_MLOC) + h * 256; const float* GT = (const float*)(F.ws + T_GTOT) + h * 256; float* MP = (float*)(F.ws + T_MPREV) + h * 256;
    float cst[8], n = 0.f, m = -1e30f;
#pragma unroll
    for (int i = 0; i < 8; ++i) cst[i] = 0.f;
    for (int c = 0; c < 256; ++c) {
        float cl[8];
#pragma unroll
        for (int i = 0; i < 8; ++i) cl[i] = CL[(size_t)c * 4096 + tid + 512 * i];
        const float nl = tid < 64 ? NL[c * 64 + tid] : 0.f;
#pragma unroll
        for (int i = 0; i < 8; ++i) CP[(size_t)c * 4096 + tid + 512 * i] = (bf16)f2bf(cst[i]);
        if (tid < 64) NP[c * 64 + tid] = n;
        if (tid == 0) MP[c] = m;
        const float gt = GT[c], ml = ML[c];
        const float mn = fmaxf(gt + m, ml), so = __expf(gt + m - mn), sl = __expf(ml - mn);
#pragma unroll
        for (int i = 0; i < 8; ++i) cst[i] = so * cst[i] + sl * cl[i];
        n = so * n + sl * nl; m = mn;
    }
}
__device__ __forceinline__ void mlstm_out(Frame& F, int L, int h, int c) {
    const int tid = F.tid, lane = F.lane, wave = F.wave, t0 = 64 * c;
    const bf16* P = (const bf16*)(F.ws + WS_HP); const bf16* QKC = (const bf16*)(F.ws + SCR_QKC);
    LAS bf16* Qs = (LAS bf16*)(F.lds); LAS bf16* Ks = (LAS bf16*)(F.lds + 9216); LAS bf16* VT = (LAS bf16*)(F.lds + 18432);
    LAS bf16* CPs = (LAS bf16*)(F.lds + 27648); LAS bf16* Pm = (LAS bf16*)(F.lds + 36864);
    LAS float* gl = (LAS float*)(F.lds + 46080); LAS float* bl = gl + 64; LAS float* mrow = gl + 128; LAS float* winter = gl + 192; LAS float* nq = gl + 256; LAS float* np = gl + 320;
    const bf16* CP = (const bf16*)(F.ws + SCR_CPREV) + (size_t)(h * 256 + c) * 4096;
    const float mprev = ((const float*)(F.ws + T_MPREV))[h * 256 + c];
    for (int e = tid; e < 64 * 64; e += NTHR) { const int l = e >> 6, j = e & 63, t = t0 + l;
        Qs[l * 72 + j] = QKC[(size_t)t * 512 + 64 * h + j]; Ks[l * 72 + j] = QKC[(size_t)t * 512 + 256 + 64 * h + j];
        VT[j * 72 + l] = P[(size_t)t * LDP + PC_MV + 64 * h + j]; CPs[l * 72 + j] = CP[l * 64 + j]; }
    if (tid < 64) { const int t = t0 + tid; const float g = ((const float*)(F.ws + T_GC))[t * 4 + h], ig = ((const float*)(F.ws + T_IG))[t * 4 + h];
        gl[tid] = g; bl[tid] = ig - g; np[tid] = ((const float*)(F.ws + T_NPREV))[(h * 256 + c) * 64 + tid]; }
    __syncthreads();
    if (tid < 64) { float bm = -1e30f; for (int s = 0; s <= tid; ++s) bm = fmaxf(bm, bl[s]);
        const float g = gl[tid], mr = g + fmaxf(mprev, bm); mrow[tid] = mr; winter[tid] = __expf(g + mprev - mr);
        float s = 0.f; for (int k = 0; k < 64; ++k) s += np[k] * bf2f(Qs[tid * 72 + k]); nq[tid] = s; }
    __syncthreads();
    if (wave < 4) {
        const int ni = wave, lq = 16 * ni + (lane & 15);
        const float g_l = gl[lq], mr = mrow[lq];
        float dsum = 0.f;
#pragma unroll
        for (int mi = 0; mi < 4; ++mi) {
            f32x4 acc = {0.f, 0.f, 0.f, 0.f}; acc = mma16(Ks + 16 * mi * 72, 72, Qs + 16 * ni * 72, 72, 64, acc, lane);
            float pv[4];
#pragma unroll
            for (int r = 0; r < 4; ++r) { const int s = 16 * mi + 4 * (lane >> 4) + r;
                const float w = (s <= lq) ? __expf(g_l + bl[s] - mr) : 0.f; pv[r] = acc[r] * w; dsum += pv[r]; }
            u32x2v w2; w2.x = pk2(pv[0], pv[1]); w2.y = pk2(pv[2], pv[3]);
            *(LAS u32x2v*)(Pm + lq * 72 + 16 * mi + 4 * (lane >> 4)) = w2;
        }
        dsum += __shfl_xor(dsum, 16); dsum += __shfl_xor(dsum, 32);
        const float wi = winter[lq];
        const float den = dsum + wi * nq[lq];
        const float inv = 1.0f / fmaxf(fabsf(den), __expf(-mr));
        LDS_WAIT(); asm volatile("" ::: "memory");
        float hv[4][4]; float ss = 0.f;
#pragma unroll
        for (int mi = 0; mi < 4; ++mi) {
            f32x4 a1 = {0.f, 0.f, 0.f, 0.f}, a2 = {0.f, 0.f, 0.f, 0.f};
            a1 = mma16(VT + 16 * mi * 72, 72, Pm + 16 * ni * 72, 72, 64, a1, lane);
            a2 = mma16(CPs + 16 * mi * 72, 72, Qs + 16 * ni * 72, 72, 64, a2, lane);
#pragma unroll
            for (int r = 0; r < 4; ++r) { const float x = (a1[r] + wi * a2[r]) * inv; hv[mi][r] = x; ss += x * x; }
        }
        ss += __shfl_xor(ss, 16); ss += __shfl_xor(ss, 32);
        const float rn = rsqrtf(ss * (1.f / 64.f) + NORM_EPS);
        const float* gn = F.in[I_MNORM] + L * 256 + 64 * h;
        bf16* YM = (bf16*)(F.ws + WS_YMIX);
        const int t = t0 + lq;
#pragma unroll
        for (int mi = 0; mi < 4; ++mi) { const int v0 = 16 * mi + 4 * (lane >> 4);
            const u32x2v ow = *(const GAS u32x2v*)(P + (size_t)t * LDP + PC_MO + 64 * h + v0);
            const float o0 = bf2f((unsigned short)(ow.x & 0xffff)), o1 = bf2f((unsigned short)(ow.x >> 16)), o2 = bf2f((unsigned short)(ow.y & 0xffff)), o3 = bf2f((unsigned short)(ow.y >> 16));
            u32x2v w; w.x = pk2(sigm(o0) * hv[mi][0] * rn * gn[v0], sigm(o1) * hv[mi][1] * rn * gn[v0 + 1]);
            w.y = pk2(sigm(o2) * hv[mi][2] * rn * gn[v0 + 2], sigm(o3) * hv[mi][3] * rn * gn[v0 + 3]);
            *(GAS u32x2v*)(YM + (size_t)t * D + 512 + 64 * h + v0) = w; }
    }
    __syncthreads();
}
__device__ __forceinline__ void attn_unit(Frame& F, int L, int g, int b) {
    const int tid = F.tid, lane = F.lane, wave = F.wave;
    const bf16* P = (const bf16*)(F.ws + WS_HP); bf16* YM = (bf16*)(F.ws + WS_YMIX);
    LAS bf16* Ks = (LAS bf16*)(F.lds); LAS bf16* VT = (LAS bf16*)(F.lds + 36864);
    LAS bf16* Pw = (LAS bf16*)(F.lds + 70656 + wave * 5376); LAS bf16* Qw = (LAS bf16*)(F.lds + 113664 + wave * 2304);
    const int tk0 = 128 * (b - 1);
    for (int e = tid; e < 2048; e += NTHR) {
        const int key = e >> 3, dc = (e & 7) * 8, t = tk0 + key;
        v4u kv = {0u, 0u, 0u, 0u}, vv = {0u, 0u, 0u, 0u};
        if (t >= 0) { kv = *(const GAS v4u*)(P + (size_t)t * LDP + PC_K + 64 * g + dc); vv = *(const GAS v4u*)(P + (size_t)t * LDP + PC_V + 64 * g + dc); }
        *(LAS v4u*)(Ks + key * 72 + dc) = kv;
        const unsigned vw[4] = {vv.x, vv.y, vv.z, vv.w};
#pragma unroll
        for (int j = 0; j < 4; ++j) { VT[(dc + 2 * j) * 264 + key] = (bf16)(vw[j] & 0xffff); VT[(dc + 2 * j + 1) * 264 + key] = (bf16)(vw[j] >> 16); }
    }
    __syncthreads();
    const int qs = wave, ks0 = qs * 16 < 96 ? qs * 16 : 96, tq0 = 128 * b + 16 * qs;
    for (int hl = 0; hl < 4; ++hl) {
        const int hq = 4 * g + hl;
        { const int r = lane >> 2, dq = (lane & 3) * 16; const GAS v4u* qp = (const GAS v4u*)(P + (size_t)(tq0 + r) * LDP + 64 * hq + dq);
          const v4u q0 = qp[0], q1 = qp[1]; *(LAS v4u*)(Qw + r * 72 + dq) = q0; *(LAS v4u*)(Qw + r * 72 + dq + 8) = q1; }
        LDS_WAIT(); asm volatile("" ::: "memory");
        const float sink = F.in[I_SINKS][L * 8 + hq];
        float s[10][4]; float mx[4] = {sink, sink, sink, sink};
#pragma unroll
        for (int i = 0; i < 10; ++i) {
            f32x4 acc = {0.f, 0.f, 0.f, 0.f}; acc = mma16(Qw, 72, Ks + (ks0 + 16 * i) * 72, 72, 64, acc, lane);
            const int tk = tk0 + ks0 + 16 * i + (lane & 15);
#pragma unroll
            for (int r = 0; r < 4; ++r) { const int tq = tq0 + 4 * (lane >> 4) + r, lag = tq - tk; const bool ok = tk >= 0 && lag >= 0 && lag < 128;
                s[i][r] = ok ? acc[r] * 0.125f : -1e30f; mx[r] = fmaxf(mx[r], s[i][r]); }
        }
#pragma unroll
        for (int r = 0; r < 4; ++r) { mx[r] = fmaxf(mx[r], __shfl_xor(mx[r], 1)); mx[r] = fmaxf(mx[r], __shfl_xor(mx[r], 2)); mx[r] = fmaxf(mx[r], __shfl_xor(mx[r], 4)); mx[r] = fmaxf(mx[r], __shfl_xor(mx[r], 8)); }
        float sm[4] = {0.f, 0.f, 0.f, 0.f};
#pragma unroll
        for (int i = 0; i < 10; ++i)
#pragma unroll
            for (int r = 0; r < 4; ++r) { const float p = s[i][r] > -1e29f ? __expf(s[i][r] - mx[r]) : 0.f; s[i][r] = p; sm[r] += p; }
#pragma unroll
        for (int r = 0; r < 4; ++r) { sm[r] += __shfl_xor(sm[r], 1); sm[r] += __shfl_xor(sm[r], 2); sm[r] += __shfl_xor(sm[r], 4); sm[r] += __shfl_xor(sm[r], 8);
            sm[r] = 1.0f / (sm[r] + __expf(sink - mx[r])); }
#pragma unroll
        for (int i = 0; i < 10; ++i)
#pragma unroll
            for (int r = 0; r < 4; ++r) Pw[(4 * (lane >> 4) + r) * 168 + 16 * i + (lane & 15)] = (bf16)f2bf(s[i][r] * sm[r]);
        LDS_WAIT(); asm volatile("" ::: "memory");
#pragma unroll
        for (int ni = 0; ni < 4; ++ni) {
            f32x4 acc = {0.f, 0.f, 0.f, 0.f}; acc = mma16(Pw, 168, VT + 16 * ni * 264 + ks0, 264, 160, acc, lane);
#pragma unroll
            for (int r = 0; r < 4; ++r) YM[(size_t)(tq0 + 4 * (lane >> 4) + r) * D + 64 * hq + 16 * ni + (lane & 15)] = (bf16)f2bf(acc[r]);
        }
        LDS_WAIT(); asm volatile("" ::: "memory");
    }
    __syncthreads();
}

__device__ __forceinline__ float rshift(const bf16* P, int t, int col, float mu) {
    const float u = bf2f(P[(size_t)t * LDP + col]); const float pv = t > 0 ? bf2f(P[(size_t)(t - 1) * LDP + col]) : 0.f; return u + (pv - u) * mu;
}
__device__ __forceinline__ void rwkv_local(Frame& F, int L, int h, int c) {
    const int tid = F.tid, lane = F.lane, wave = F.wave, t0 = 64 * c;
    const bf16* P = (const bf16*)(F.ws + WS_HP);
    LAS float* OPS = (LAS float*)(F.lds); LAS float* VV = (LAS float*)(F.lds + 81920);
    LAS bf16* XW = (LAS bf16*)(F.lds + 81920); LAS bf16* XA = (LAS bf16*)(F.lds + 91136); LAS bf16* WUPT = (LAS bf16*)(F.lds + 100352); LAS bf16* AUPT = (LAS bf16*)(F.lds + 109568);
    const float* mu = F.in[I_RMU] + L * 1024;
    const float* wup = F.in[I_RWUP] + (size_t)L * 64 * 256; const float* aup = F.in[I_RAUP] + (size_t)L * 64 * 256;
    for (int e = tid; e < 4096; e += NTHR) { const int t = e >> 6, i = e & 63;
        XW[t * 72 + i] = (bf16)f2bf(tanhf(rshift(P, t0 + t, PC_RW + i, mu[PC_RW - PC_R + i])));
        XA[t * 72 + i] = (bf16)f2bf(rshift(P, t0 + t, PC_RA + i, mu[PC_RA - PC_R + i]));
        WUPT[i * 72 + t] = (bf16)f2bf(wup[t * 256 + 64 * h + i]); AUPT[i * 72 + t] = (bf16)f2bf(aup[t * 256 + 64 * h + i]); }
    __syncthreads();
#pragma unroll
    for (int q = 0; q < 4; ++q) { const int tix = wave * 4 + q, isa = tix >> 4, mi = (tix >> 2) & 3, ni = tix & 3;
        f32x4 acc = {0.f, 0.f, 0.f, 0.f};
        acc = mma16((isa ? XA : XW) + 16 * mi * 72, 72, (isa ? AUPT : WUPT) + 16 * ni * 72, 72, 64, acc, lane);
        const int j = 16 * ni + (lane & 15);
        const float b0 = isa ? F.in[I_RA0][L * 256 + 64 * h + j] : F.in[I_RW0][L * 256 + 64 * h + j];
#pragma unroll
        for (int r = 0; r < 4; ++r) { const int t = 16 * mi + 4 * (lane >> 4) + r; const float z = b0 + acc[r]; float o;
            if (isa) o = sigm(z);
            else { const float sp = fmaxf(-z, 0.f) + log1pf(__expf(-fabsf(z))); o = __expf(-__expf(-sp - 0.5f)); }
            OPS[t * 320 + (isa ? 64 : 0) + j] = o; }
    }
    __syncthreads();
    {
        const int j = lane, cj = 64 * h + j;
        const float kkw = F.in[I_RKK][L * 256 + cj], kaw = F.in[I_RKA][L * 256 + cj], rkw = F.in[I_RRK][L * 256 + cj];
        const float mur = mu[PC_RR - PC_R + cj], muk = mu[PC_RK - PC_R + cj], muv = mu[PC_RV - PC_R + cj];
        for (int tt = 0; tt < 8; ++tt) { const int t = 8 * wave + tt, tg = t0 + t;
            const float r = rshift(P, tg, PC_RR + cj, mur), k = rshift(P, tg, PC_RK + cj, muk), v = rshift(P, tg, PC_RV + cj, muv);
            const float alr = OPS[t * 320 + 64 + j];
            const float kkv = k * kkw; const float ssq = wave_sum(kkv * kkv); const float kk = kkv * rsqrtf(fmaxf(ssq, 1e-24f));
            const float kp = k * (1.f + (alr - 1.f) * kaw);
            const float bon = wave_sum(r * kp * rkw);
            OPS[t * 320 + 64 + j] = -kk; OPS[t * 320 + 128 + j] = kk * alr; OPS[t * 320 + 192 + j] = kp; OPS[t * 320 + 256 + j] = r; VV[t * 64 + j] = v;
            if (lane == 0) ((float*)(F.ws + T_BONUS))[tg * 4 + h] = bon; }
    }
    __syncthreads();
    {
        const int rl = lane >> 2, q4 = lane & 3, row = 16 * wave + rl; const bool isU = wave < 4;
        float S[16];
#pragma unroll
        for (int j = 0; j < 16; ++j) S[j] = (!isU && (16 * q4 + j) == (row - 64)) ? 1.f : 0.f;
        float* YT = (float*)(F.ws + SCR_YT); bf16* PT = (bf16*)(F.ws + SCR_PT);
        for (int t = 0; t < 64; ++t) {
            const LAS f32x4* op = (const LAS f32x4*)(OPS + t * 320 + 16 * q4);
            f32x4 w4[4], a4[4], b4[4], k4[4], r4[4];
#pragma unroll
            for (int i = 0; i < 4; ++i) { w4[i] = op[i]; a4[i] = op[16 + i]; b4[i] = op[32 + i]; k4[i] = op[48 + i]; r4[i] = op[64 + i]; }
            float sa = 0.f;
#pragma unroll
            for (int j = 0; j < 16; ++j) sa += S[j] * a4[j >> 2][j & 3];
            sa += __shfl_xor(sa, 1); sa += __shfl_xor(sa, 2);
            const float vt = isU ? VV[t * 64 + row] : 0.f;
            float y = 0.f;
#pragma unroll
            for (int j = 0; j < 16; ++j) { S[j] = S[j] * w4[j >> 2][j & 3] + sa * b4[j >> 2][j & 3] + vt * k4[j >> 2][j & 3]; y += S[j] * r4[j >> 2][j & 3]; }
            y += __shfl_xor(y, 1); y += __shfl_xor(y, 2);
            if (q4 == 0) { if (isU) YT[(size_t)(t0 + t) * 256 + 64 * h + row] = y; else PT[(size_t)(t0 + t) * 256 + 64 * h + row - 64] = (bf16)f2bf(y); }
        }
        if (isU) { float* UC = (float*)(F.ws + SCR_UC) + (size_t)(h * 256 + c) * 4096;
#pragma unroll
            for (int j = 0; j < 16; ++j) UC[(16 * q4 + j) * 64 + row] = S[j]; }
        else { bf16* PTC = (bf16*)(F.ws + SCR_PTC) + (size_t)(h * 256 + c) * 4096;
#pragma unroll
            for (int j = 0; j < 16; ++j) PTC[(16 * q4 + j) * 64 + row - 64] = (bf16)f2bf(S[j]); }
    }
    __syncthreads();
}
__device__ __forceinline__ void rwkv_scan(Frame& F, int w16) {
    const int tid = F.tid, lane = F.lane, wave = F.wave, h = w16 >> 2, vs = w16 & 3;
    LAS bf16* SA = (LAS bf16*)(F.lds);
    for (int e = tid; e < 16 * 72; e += NTHR) SA[e] = 0;
    __syncthreads();
    const bf16* PTC = (const bf16*)(F.ws + SCR_PTC) + (size_t)h * 256 * 4096; const float* UC = (const float*)(F.ws + SCR_UC) + (size_t)h * 256 * 4096;
    bf16* SC = (bf16*)(F.ws + SCR_SC) + (size_t)h * 256 * 4096;
    for (int c = 0; c < 256; ++c) {
        f32x4 accn = {0.f, 0.f, 0.f, 0.f};
        if (wave < 4) {
            const int ni = wave;
            const bf16x8 a0 = *(const LAS bf16x8*)(SA + (lane & 15) * 72 + 8 * (lane >> 4)), a1 = *(const LAS bf16x8*)(SA + (lane & 15) * 72 + 32 + 8 * (lane >> 4));
            if (wave == 0) { GAS bf16x8* sp = (GAS bf16x8*)(SC + (size_t)c * 4096 + (16 * vs + (lane & 15)) * 64 + 8 * (lane >> 4)); sp[0] = a0; sp[4] = a1; }
            const GAS bf16x8* bp = (const GAS bf16x8*)(PTC + (size_t)c * 4096 + (16 * ni + (lane & 15)) * 64 + 8 * (lane >> 4));
            const bf16x8 b0 = bp[0], b1 = bp[4];
            accn = *(const GAS f32x4*)(UC + (size_t)c * 4096 + (16 * ni + (lane & 15)) * 64 + 16 * vs + 4 * (lane >> 4));
            accn = __builtin_amdgcn_mfma_f32_16x16x32_bf16(a0, b0, accn, 0, 0, 0);
            accn = __builtin_amdgcn_mfma_f32_16x16x32_bf16(a1, b1, accn, 0, 0, 0);
        }
        __syncthreads();
        if (wave < 4) {
#pragma unroll
            for (int r = 0; r < 4; ++r) SA[(4 * (lane >> 4) + r) * 72 + 16 * wave + (lane & 15)] = (bf16)f2bf(accn[r]);
        }
        __syncthreads();
    }
}
__device__ __forceinline__ void rwkv_out(Frame& F, int L, int h, int c) {
    const int tid = F.tid, lane = F.lane, wave = F.wave, t0 = 64 * c;
    const bf16* P = (const bf16*)(F.ws + WS_HP);
    LAS bf16* SCs = (LAS bf16*)(F.lds); LAS bf16* PTs = (LAS bf16*)(F.lds + 9216); LAS bf16* XG = (LAS bf16*)(F.lds + 18432); LAS bf16* GUPT = (LAS bf16*)(F.lds + 35840);
    const bf16* SC = (const bf16*)(F.ws + SCR_SC) + (size_t)(h * 256 + c) * 4096; const bf16* PT = (const bf16*)(F.ws + SCR_PT);
    const float* mu = F.in[I_RMU] + L * 1024; const float* gup = F.in[I_RGUP] + (size_t)L * 128 * 256;
    for (int e = tid; e < 4096; e += NTHR) { const int r = e >> 6, i = e & 63; SCs[r * 72 + i] = SC[r * 64 + i]; PTs[r * 72 + i] = PT[(size_t)(t0 + r) * 256 + 64 * h + i]; }
    for (int e = tid; e < 8192; e += NTHR) { const int t = e >> 7, i = e & 127;
        XG[t * 136 + i] = (bf16)f2bf(sigm(rshift(P, t0 + t, PC_RG + i, mu[PC_RG - PC_R + i])));
        const int v = e & 63, ii = e >> 6;
        GUPT[v * 136 + ii] = (bf16)f2bf(gup[ii * 256 + 64 * h + v]); }
    __syncthreads();
    if (wave < 4) {
        const int ni = wave, t = 16 * ni + (lane & 15), tg = t0 + t;
        float y[4][4], gg[4][4]; float sum = 0.f;
        const float* YT = (const float*)(F.ws + SCR_YT);
#pragma unroll
        for (int mi = 0; mi < 4; ++mi) {
            f32x4 ay = {0.f, 0.f, 0.f, 0.f}, ag = {0.f, 0.f, 0.f, 0.f};
            ay = mma16(SCs + 16 * mi * 72, 72, PTs + 16 * ni * 72, 72, 64, ay, lane);
            ag = mma16(GUPT + 16 * mi * 136, 136, XG + 16 * ni * 136, 136, 128, ag, lane);
            const f32x4 yl = *(const GAS f32x4*)(YT + (size_t)tg * 256 + 64 * h + 16 * mi + 4 * (lane >> 4));
#pragma unroll
            for (int r = 0; r < 4; ++r) { y[mi][r] = ay[r] + yl[r]; gg[mi][r] = ag[r]; sum += y[mi][r]; }
        }
        sum += __shfl_xor(sum, 16); sum += __shfl_xor(sum, 32);
        const float mean = sum * (1.f / 64.f); float var = 0.f;
#pragma unroll
        for (int mi = 0; mi < 4; ++mi)
#pragma unroll
            for (int r = 0; r < 4; ++r) { const float d = y[mi][r] - mean; var += d * d; }
        var += __shfl_xor(var, 16); var += __shfl_xor(var, 32);
        const float rs = rsqrtf(var * (1.f / 64.f) + 64e-5f);
        const float bon = ((const float*)(F.ws + T_BONUS))[tg * 4 + h];
        bf16* YM = (bf16*)(F.ws + WS_YMIX);
#pragma unroll
        for (int mi = 0; mi < 4; ++mi) { const int v0 = 16 * mi + 4 * (lane >> 4); float o[4];
#pragma unroll
            for (int r = 0; r < 4; ++r) { const int cj = 64 * h + v0 + r;
                const float yn = (y[mi][r] - mean) * rs * F.in[I_RLNW][L * 256 + cj] + F.in[I_RLNB][L * 256 + cj];
                const float vv = rshift(P, tg, PC_RV + cj, mu[PC_RV - PC_R + cj]);
                o[r] = (yn + bon * vv) * gg[mi][r]; }
            u32x2v w; w.x = pk2(o[0], o[1]); w.y = pk2(o[2], o[3]);
            *(GAS u32x2v*)(YM + (size_t)tg * D + 768 + 64 * h + v0) = w; }
    }
    __syncthreads();
}
#ifndef PHMASK
#define PHMASK 0xffffffffu
#endif
#define PHON(k) ((PHMASK >> (k)) & 1u)
#ifndef MK_PER_PHASE
#define MK_PER_PHASE 0
#endif
constexpr int LDS_BYTES = 147456, MISC_OFF = 146944;
constexpr int PH_PER_LAYER = 14, N_PHASES = 1 + PH_PER_LAYER * DEPTH;
constexpr size_t WS_PBF = 62 * MiB;
__device__ __forceinline__ unsigned long long launder_u64(unsigned long long v) {
    unsigned lo = __builtin_amdgcn_readfirstlane((unsigned)v), hi = __builtin_amdgcn_readfirstlane((unsigned)(v >> 32));
    asm volatile("" : "+s"(lo), "+s"(hi));
    return ((unsigned long long)hi << 32) | lo;
}
__device__ __forceinline__ void launder_frame(Frame& F) {
    F.ws = (unsigned char*)launder_u64((unsigned long long)F.ws); F.out = (float*)launder_u64((unsigned long long)F.out); F.in = (kargp)launder_u64((unsigned long long)F.in);
    int t = F.tid; asm volatile("" : "+v"(t)); F.tid = t; F.lane = t & 63;
    int b = __builtin_amdgcn_readfirstlane(F.bid), g = __builtin_amdgcn_readfirstlane(F.G), w = __builtin_amdgcn_readfirstlane(t >> 6);
    asm volatile("" : "+s"(b), "+s"(g), "+s"(w)); F.bid = b; F.G = g; F.wave = w;
}
struct Args { const float* in[N_IN]; float* out; unsigned char* ws; int ph_lo, ph_hi; };

__global__ void __launch_bounds__(NTHR, 2) hybrid_fwd(Args args) {
    extern __shared__ __attribute__((aligned(16))) unsigned char lds[];
    Frame F;
    F.lds = (LAS unsigned char*)lds;
    F.MISC = (volatile LAS unsigned*)(F.lds + MISC_OFF);
    F.tid = threadIdx.x; F.lane = F.tid & 63; F.wave = __builtin_amdgcn_readfirstlane(F.tid >> 6);
    F.G = gridDim.x; F.bid = blockIdx.x;
    F.in = (kargp)__builtin_amdgcn_kernarg_segment_ptr();
    F.out = args.out; F.ws = args.ws; F.ctl = (gu32*)(args.ws + WS_CTL);
    for (int u = F.tid; u < (LDS_BYTES - MISC_OFF) / 4; u += NTHR) ((LAS unsigned*)(F.lds + MISC_OFF))[u] = 0u;
    __syncthreads();
    XcdBarrier bar; bar.bar = (unsigned*)(F.ctl + CW_BAR); bar.x = 0; bar.st = nullptr;
    if (!MK_PER_PHASE) bar = xcd_barrier_post((unsigned*)(F.ctl + CW_BAR), F.MISC + 8);
#define GRID_BAR() do { if (!MK_PER_PHASE) xcd_barrier(bar); } while (0)
    const int lo = args.ph_lo, hi = args.ph_hi;
#define IN(k) (lo <= (k) && (k) < hi)
#define SEAM(k) do { if (IN(k) && IN((k) + 1)) GRID_BAR(); } while (0)
#define PH_SETUP() launder_frame(F); unsigned char* ws = F.ws; bf16* XN = (bf16*)(ws + WS_XN); bf16* Y = (bf16*)(ws + WS_Y); bf16* PP = (bf16*)(ws + WS_PP); bf16* YMIX = (bf16*)(ws + WS_YMIX); bf16* HB = (bf16*)(ws + WS_HP); bf16* PBF = (bf16*)(ws + WS_PBF); (void)XN; (void)Y; (void)PP; (void)YMIX; (void)HB; (void)PBF

    if (PHON(0) && IN(0)) { PH_SETUP();
        rope_table(F);
        conv_weights(F, 0);
        row_phase(F, F.in[I_X], nullptr, 0.f, nullptr, F.in[I_LN_F1PRE], F.out, XN);
    }
    SEAM(0);
    for (int L = 0; L < DEPTH; ++L) {
        const int pb = 1 + PH_PER_LAYER * L;
        if (PHON(1) && IN(pb + 0)) { PH_SETUP();
            pg8::Gemm g{XN, (const bf16*)(ws + WS_W1A), M, NFF2, D}; pg8::StaticOrder S; S.init(M, NFF2, F.G, F.bid);
            pg8::EpiSwiglu E{HB, FF};
            pg8::gemm_phase<pg8::EpiSwiglu, pg8::StaticOrder, true, true>(F.lds, g, S, E);
        }
        SEAM(pb + 0);
        if (PHON(2) && IN(pb + 1)) { PH_SETUP();
            pg8::Gemm g{HB, (const bf16*)(ws + WS_W1B), M, D, FF}; pg8::StaticOrder S; S.init(M, D, F.G, F.bid);
            pg8::EpiBf16G E{Y, D, D};
            pg8::gemm_phase<pg8::EpiBf16G, pg8::StaticOrder, true, true>(F.lds, g, S, E);
        }
        SEAM(pb + 1);
        if (PHON(3) && IN(pb + 2)) { PH_SETUP(); row_phase(F, F.out, Y, 0.5f, F.in[I_LN_F1POST] + L * D, F.in[I_LN_MIXPRE] + L * D, F.out, XN); }
        SEAM(pb + 2);
        if (PHON(4) && IN(pb + 3)) { PH_SETUP();
            pg8::Gemm g{XN, (const bf16*)(ws + WS_WIN), M, DINP, D}; pg8::StaticOrder S; S.init(M, DINP, F.G, F.bid);
            pg8::EpiBf16G E{HB, LDP, DIN};
            pg8::gemm_phase<pg8::EpiBf16G, pg8::StaticOrder, true, true>(F.lds, g, S, E);
        }
        SEAM(pb + 3);
        if (PHON(5) && IN(pb + 4)) { PH_SETUP();
            rope_inplace(F);
            for (int u = F.bid; u < 1024; u += F.G) mlstm_local(F, L, u & 3, u >> 2);
            for (int u = F.bid; u < 1024; u += F.G) rwkv_local(F, L, u & 3, u >> 2);
        }
        SEAM(pb + 4);
        if (PHON(6) && IN(pb + 5)) { PH_SETUP();
            if (F.G >= 64) {
                if (F.bid < 16) rwkv_scan(F, F.bid);
                else if (F.bid < 20) mlstm_scan(F, F.bid - 16);
                else for (int u = F.bid - 20; u < 256; u += F.G - 20) attn_unit(F, L, u & 1, u >> 1);
            } else {
                for (int w = F.bid; w < 16; w += F.G) rwkv_scan(F, w);
                for (int w = F.bid; w < 4; w += F.G) mlstm_scan(F, w);
                for (int u = F.bid; u < 256; u += F.G) attn_unit(F, L, u & 1, u >> 1);
            }
        }
        SEAM(pb + 5);
        if (PHON(7) && IN(pb + 6)) { PH_SETUP();
            for (int u = F.bid; u < 1024; u += F.G) mlstm_out(F, L, u & 3, u >> 2);
            for (int u = F.bid; u < 1024; u += F.G) rwkv_out(F, L, u & 3, u >> 2);
            conv_p(F, L, PBF);
        }
        SEAM(pb + 6);
        if (PHON(8) && IN(pb + 7)) { PH_SETUP();
            { pg8::Gemm g{YMIX, (const bf16*)(ws + WS_WOUT), M, D, D}; pg8::StaticOrder S; S.init(M, D, F.G, F.bid);
              pg8::EpiBf16G E{Y, D, D};
              pg8::gemm_phase<pg8::EpiBf16G, pg8::StaticOrder, true, true>(F.lds, g, S, E); }
            launder_frame(F);
            { unsigned char* ws2 = F.ws; bf16* PBF2 = (bf16*)(ws2 + WS_PBF); bf16* PP2 = (bf16*)(ws2 + WS_PP);
              pg8::Gemm g{PBF2, (const bf16*)(ws2 + WS_WP), M, D, DPLE}; pg8::StaticOrder S; S.init(M, D, F.G, F.bid);
              pg8::EpiBf16G E{PP2, D, D};
              pg8::gemm_phase<pg8::EpiBf16G, pg8::StaticOrder, true, true>(F.lds, g, S, E); }
        }
        SEAM(pb + 7);
        if (PHON(9) && IN(pb + 8)) { PH_SETUP(); row_phase(F, F.out, Y, 1.0f, F.in[I_LN_MIXPOST] + L * D, F.in[I_LN_F2PRE] + L * D, F.out, XN); }
        SEAM(pb + 8);
        if (PHON(10) && IN(pb + 9)) { PH_SETUP();
            pg8::Gemm g{XN, (const bf16*)(ws + WS_W2A), M, NFF2, D}; pg8::StaticOrder S; S.init(M, NFF2, F.G, F.bid);
            pg8::EpiSwiglu E{HB, FF};
            pg8::gemm_phase<pg8::EpiSwiglu, pg8::StaticOrder, true, true>(F.lds, g, S, E);
        }
        SEAM(pb + 9);
        if (PHON(11) && IN(pb + 10)) { PH_SETUP();
            pg8::Gemm g{HB, (const bf16*)(ws + WS_W2B), M, D, FF}; pg8::StaticOrder S; S.init(M, D, F.G, F.bid);
            pg8::EpiBf16G E{Y, D, D};
            pg8::gemm_phase<pg8::EpiBf16G, pg8::StaticOrder, true, true>(F.lds, g, S, E);
        }
        SEAM(pb + 10);
        if (PHON(12) && IN(pb + 11)) { PH_SETUP(); row_phase(F, F.out, Y, 0.5f, F.in[I_LN_F2POST] + L * D, F.in[I_LN_PLEPRE] + L * D, F.out, XN); }
        SEAM(pb + 11);
        if (PHON(13) && IN(pb + 12)) { PH_SETUP();
            pg8::Gemm g{XN, (const bf16*)(ws + WS_WG), M, D, D}; pg8::StaticOrder S; S.init(M, D, F.G, F.bid);
            pg8::EpiPle E{Y, PP, D};
            pg8::gemm_phase<pg8::EpiPle, pg8::StaticOrder, true, true>(F.lds, g, S, E);
        }
        SEAM(pb + 12);
        if (PHON(14) && IN(pb + 13)) { PH_SETUP();
            const bool more = (L + 1 < DEPTH);
            row_phase(F, F.out, Y, 1.0f, F.in[I_LN_PLEPOST] + L * D, more ? F.in[I_LN_F1PRE] + (L + 1) * D : nullptr, F.out, XN);
            if (more) conv_weights(F, L + 1);
        }
        SEAM(pb + 13);
    }
#undef IN
#undef SEAM
}

extern "C" void kernel_launch(void* const* d_in, const int* in_sizes, int n_in, void* d_out, int out_size, void* d_ws, size_t ws_size, hipStream_t stream) {
    static int grid = 0;
    if (grid == 0) {
        if (n_in != N_IN || in_sizes[0] != M * D || out_size != M * D || ws_size < WS_END) {
            fprintf(stderr, "kernel_launch: unexpected shapes: n_in %d in0 %d out %d ws %zu (need %zu)\n", n_in, n_in > 0 ? in_sizes[0] : -1, out_size, ws_size, (size_t)WS_END); grid = -1; return; }
        int dev = 0, cus = 0;
        if (hipGetDevice(&dev) != hipSuccess || hipDeviceGetAttribute(&cus, hipDeviceAttributeMultiprocessorCount, dev) != hipSuccess) { grid = -1; return; }
        if (hipFuncSetAttribute((const void*)hybrid_fwd, hipFuncAttributeMaxDynamicSharedMemorySize, LDS_BYTES) != hipSuccess) { fprintf(stderr, "kernel_launch: hipFuncSetAttribute failed\n"); grid = -1; return; }
        int per_cu = 0;
        if (hipOccupancyMaxActiveBlocksPerMultiprocessor(&per_cu, (const void*)hybrid_fwd, NTHR, LDS_BYTES) != hipSuccess || per_cu < 1)
            fprintf(stderr, "kernel_launch: occupancy query reports %d blocks per CU\n", per_cu);
        (void)hipGetLastError();
        grid = cus;
    }
    if (grid < 0) return;
    (void)hipMemsetAsync((char*)d_ws + WS_CTL, 0, CTL_ZERO_BYTES, stream);
    Args a{};
    for (int i = 0; i < N_IN; ++i) a.in[i] = (const float*)d_in[i];
    a.out = (float*)d_out; a.ws = (unsigned char*)d_ws;
#if MK_PER_PHASE
    for (int p = 0; p < N_PHASES; ++p) { a.ph_lo = p; a.ph_hi = p + 1; hipLaunchKernelGGL(hybrid_fwd, dim3(grid), dim3(NTHR), LDS_BYTES, stream, a); }
#else
    a.ph_lo = 0; a.ph_hi = N_PHASES;
    hipLaunchKernelGGL(hybrid_fwd, dim3(grid), dim3(NTHR), LDS_BYTES, stream, a);
#endif
    const hipError_t le = hipPeekAtLastError();
    if (le != hipSuccess) fprintf(stderr, "kernel_launch: launch failed: %s\n", hipGetErrorName(le));
}
```
